# Optimizing an MI355X kernel written in HIP

```python
import math
import jax
import jax.numpy as jnp
from jax import lax
import numpy as np

D_MODEL = 2048
BATCH = 2
SEQ = 8192
DEPTH = 4
DEC_BATCH = 4
DEC_SEQ = 2048
PAST_LEN = 128

HEAD_DIM = 64
GRID_W = 64
NA_HEADS = 8
NA_ROWS = 8
NA_COLS = 16
DIL_PATTERNS = ((128, 1), (512, 4), (2048, 16))
DIL_HEADS_PER_GROUP = 4
DIL_HEADS = 12
DIL_BLOCK = 64
GA_Q_HEADS = 8
GA_KV_HEADS = 2
GA_BLOCK = 128
ROPE_THETA = 10000.0
SW_Q_HEADS = 8
SW_KV_HEADS = 2
SW_HALF_WINDOW = 128
SW_BLOCK = 128

N_BRANCHES = 4
D_FF = 4 * D_MODEL
RMS_EPS = 1e-6
NEG_INF = -1e30

A_W = NA_HEADS * HEAD_DIM
B_W = DIL_HEADS * HEAD_DIM
B_OUT = DIL_HEADS_PER_GROUP * HEAD_DIM
C_QW = GA_Q_HEADS * HEAD_DIM
C_KVW = GA_KV_HEADS * HEAD_DIM
D_QW = SW_Q_HEADS * HEAD_DIM
D_KVW = SW_KV_HEADS * HEAD_DIM
GATE_W = N_BRANCHES * D_MODEL
SPLIT_SIZES = (A_W, A_W, A_W, B_W, B_W, B_W, C_QW, C_KVW, C_KVW, D_QW, D_KVW, D_KVW, GATE_W)
IN_WIDTH = 3 * A_W + 3 * B_W + C_QW + 2 * C_KVW + D_QW + 2 * D_KVW + GATE_W

kernel_name = "hybrid_natten_dilated_axial_sink_encoder"


def rmsnorm(x, g):
    xf = x.astype(jnp.float32)
    y = xf * lax.rsqrt(jnp.mean(xf * xf, axis=-1, keepdims=True) + RMS_EPS)
    return (y * g.astype(jnp.float32)).astype(x.dtype)


def alibi_slopes(n):
    return (2.0 ** (-8.0 * np.arange(1, n + 1) / n)).astype(np.float32)


def axial_rope(x):
    L = x.shape[1]
    t = jnp.arange(L)
    half = HEAD_DIM // 2

    def rot(xp, pos):
        npair = xp.shape[-1] // 2
        freqs = ROPE_THETA ** (-jnp.arange(npair, dtype=jnp.float32) / npair)
        ang = pos.astype(jnp.float32)[:, None] * freqs[None, :]
        cos = jnp.cos(ang)[None, :, None, :].astype(x.dtype)
        sin = jnp.sin(ang)[None, :, None, :].astype(x.dtype)
        x1, x2 = xp[..., :npair], xp[..., npair:]
        return jnp.concatenate([x1 * cos - x2 * sin, x2 * cos + x1 * sin], axis=-1)

    return jnp.concatenate([rot(x[..., :half], t // GRID_W), rot(x[..., half:], t % GRID_W)], axis=-1)


def neighborhood_attention(q, k, v, rel_bias):
    B, L, H, Dh = q.shape
    R = L // GRID_W
    KH = min(NA_ROWS, R)
    NCB = GRID_W // NA_COLS
    KWB = 2 * NA_COLS
    qc = np.arange(GRID_W).reshape(NCB, NA_COLS)
    kc = np.clip(np.arange(NCB) * NA_COLS - NA_COLS // 2, 0, GRID_W - KWB)[:, None] + np.arange(KWB)
    c0 = np.clip(qc - NA_COLS // 2, 0, GRID_W - NA_COLS)
    col_valid = (kc[:, None, :] >= c0[..., None]) & (kc[:, None, :] < c0[..., None] + NA_COLS)
    dc = np.clip(kc[:, None, :] - qc[..., None], -(NA_COLS - 1), NA_COLS - 1) + NA_COLS - 1
    col_bias = rel_bias[:, :, dc]
    kg = k.reshape(B, R, GRID_W, H, Dh)
    vg = v.reshape(B, R, GRID_W, H, Dh)
    qg = q.reshape(B, R, NCB, NA_COLS, H, Dh)
    scale = Dh ** -0.5

    def row_step(r):
        r0 = jnp.clip(r - KH // 2, 0, R - KH)
        k_blk = lax.dynamic_slice_in_dim(kg, r0, KH, axis=1)[:, :, kc]
        v_blk = lax.dynamic_slice_in_dim(vg, r0, KH, axis=1)[:, :, kc]
        q_row = lax.dynamic_index_in_dim(qg, r, axis=1, keepdims=False)
        s = jnp.einsum('bnqhd,bknjhd->bhnqkj', q_row, k_blk).astype(jnp.float32) * scale
        dr = r0 + jnp.arange(KH) - r + NA_ROWS - 1
        bias = jnp.transpose(col_bias[:, dr], (0, 2, 3, 1, 4)).astype(jnp.float32)
        s = jnp.where(col_valid[None, None, :, :, None, :], s + bias[None], NEG_INF)
        p = jax.nn.softmax(s.reshape(B, H, NCB, NA_COLS, KH * KWB), axis=-1).reshape(s.shape)
        o = jnp.einsum('bhnqkj,bknjhd->bnqhd', p.astype(v.dtype), v_blk)
        return o.reshape(B, GRID_W, H, Dh)

    out = lax.map(row_step, jnp.arange(R))
    return jnp.moveaxis(out, 0, 1).reshape(B, L, H * Dh)


def banded_attention(q, k, v, half_window, block, slopes, dist_scale, sink):
    N, n, Hq, Dh = q.shape
    Hkv = k.shape[2]
    G = Hq // Hkv
    nb = -(-n // block)
    npad = nb * block
    qp = jnp.pad(q, ((0, 0), (0, npad - n), (0, 0), (0, 0))).reshape(N, nb, block, Hkv, G, Dh)

    def windows(t):
        tp = jnp.pad(t, ((0, 0), (block, npad - n + block), (0, 0), (0, 0))).reshape(N, nb + 2, block, Hkv, Dh)
        return jnp.concatenate([tp[:, :-2], tp[:, 1:-1], tp[:, 2:]], axis=2)

    kw = windows(k)
    vw = windows(v)
    s = jnp.einsum('nbqkgd,nbskd->nbkgqs', qp, kw).astype(jnp.float32) * (Dh ** -0.5)
    delta = np.arange(3 * block)[None, :] - block - np.arange(block)[:, None]
    kpos = (np.arange(nb)[:, None] - 1) * block + np.arange(3 * block)[None, :]
    valid = (np.abs(delta)[None] <= half_window) & (kpos[:, None, :] >= 0) & (kpos[:, None, :] < n)
    bias = -slopes.reshape(Hkv, G)[:, :, None, None] * (dist_scale * np.abs(delta)).astype(np.float32)[None, None]
    s = jnp.where(valid[None, :, None, None], s + bias, NEG_INF)
    m = jnp.max(s, axis=-1)
    if sink is not None:
        sk = sink.astype(jnp.float32).reshape(Hkv, G)[:, :, None]
        m = jnp.maximum(m, sk)
    p = jnp.exp(s - m[..., None])
    denom = jnp.sum(p, axis=-1)
    if sink is not None:
        denom = denom + jnp.exp(sk - m)
    o = jnp.einsum('nbkgqs,nbskd->nbqkgd', (p / denom[..., None]).astype(v.dtype), vw)
    lse = jnp.transpose(m + jnp.log(denom), (0, 1, 4, 2, 3))
    return (o.reshape(N, npad, Hq, Dh)[:, :n], lse.reshape(N, npad, Hq)[:, :n])


def dilated_attention(q, k, v):
    B, L, _, Dh = q.shape
    slopes = alibi_slopes(DIL_HEADS)
    hg = DIL_HEADS_PER_GROUP
    outs = []
    lses = []
    for g, (w, d) in enumerate(DIL_PATTERNS):
        n = L // d
        sl = slice(g * hg, (g + 1) * hg)

        def fold(t):
            return t.reshape(B, n, d, hg, Dh).swapaxes(1, 2).reshape(B * d, n, hg, Dh)

        o, lse = banded_attention(fold(q[:, :, sl]), fold(k[:, :, sl]), fold(v[:, :, sl]),
                                  w // (2 * d), DIL_BLOCK, slopes[sl], d, None)
        outs.append(o.reshape(B, d, n, hg, Dh).swapaxes(1, 2).reshape(B, L, hg, Dh))
        lses.append(lse.reshape(B, d, n, hg).swapaxes(1, 2).reshape(B, L, hg))
    wts = jax.nn.softmax(jnp.stack(lses, axis=0), axis=0)
    out = jnp.sum(wts[..., None] * jnp.stack(outs, axis=0).astype(jnp.float32), axis=0)
    return out.astype(q.dtype).reshape(B, L, hg * Dh)


def axial_global_attention(q, k, v, q_gain, k_gain):
    B, L, Hq, Dh = q.shape
    Hkv = k.shape[2]
    G = Hq // Hkv
    q = axial_rope(rmsnorm(q, q_gain))
    k = axial_rope(rmsnorm(k, k_gain))
    nqb = L // GA_BLOCK
    qb = jnp.moveaxis(q.reshape(B, nqb, GA_BLOCK, Hkv, G, Dh), 1, 0)
    scale = Dh ** -0.5

    def step(qblk):
        s = jnp.einsum('bqkgd,bskd->bkgqs', qblk, k).astype(jnp.float32) * scale
        p = jax.nn.softmax(s, axis=-1)
        return jnp.einsum('bkgqs,bskd->bqkgd', p.astype(v.dtype), v)

    o = lax.map(step, qb)
    return jnp.moveaxis(o, 0, 1).reshape(B, L, Hq * Dh)


def mixer_sublayer(x, norm_g, w_in, rel_bias_a, q_gain_c, k_gain_c, sink_d, w_a, w_b, w_c, w_d, w_out):
    B, L, _ = x.shape
    h = rmsnorm(x, norm_g)
    parts = jnp.split(h @ w_in, np.cumsum(SPLIT_SIZES)[:-1].tolist(), axis=-1)
    aq, ak, av, bq, bk, bv, cq, ck, cv, dq, dk, dv, gl = parts

    def hd(t):
        return t.reshape(B, L, -1, HEAD_DIM)

    ya = neighborhood_attention(hd(aq), hd(ak), hd(av), rel_bias_a)
    yb = dilated_attention(hd(bq), hd(bk), hd(bv))
    yc = axial_global_attention(hd(cq), hd(ck), hd(cv), q_gain_c, k_gain_c)
    yd, _ = banded_attention(hd(dq), hd(dk), hd(dv), SW_HALF_WINDOW, SW_BLOCK,
                             alibi_slopes(SW_Q_HEADS), 1, sink_d)
    yd = yd.reshape(B, L, D_QW)
    g = jax.nn.sigmoid(gl).reshape(B, L, N_BRANCHES, D_MODEL)
    merged = (g[:, :, 0] * (ya @ w_a) + g[:, :, 1] * (yb @ w_b)
              + g[:, :, 2] * (yc @ w_c) + g[:, :, 3] * (yd @ w_d))
    return x + merged @ w_out


def mlp_sublayer(x, norm_g, w_up, w_down):
    h = rmsnorm(x, norm_g)
    return x + jnp.square(jax.nn.relu(h @ w_up)) @ w_down


def trunk(x, norm_mix, w_in, rel_bias_a, q_gain_c, k_gain_c, sink_d, w_branch_a, w_branch_b,
          w_branch_c, w_branch_d, w_out, norm_mlp, w_up, w_down, norm_final):
    for l in range(DEPTH):
        x = mixer_sublayer(x, norm_mix[l], w_in[l], rel_bias_a[l], q_gain_c[l], k_gain_c[l], sink_d[l],
                           w_branch_a[l], w_branch_b[l], w_branch_c[l], w_branch_d[l], w_out[l])
        x = mlp_sublayer(x, norm_mlp[l], w_up[l], w_down[l])
    return rmsnorm(x, norm_final)


def setup_inputs(seed: int = 0) -> dict:
    key = jax.random.key(seed)
    ks = jax.random.split(key, 18)

    def nrm(k, shape, scale):
        return jax.random.normal(k, shape, jnp.float32) * scale

    return {
        "x_prompt": nrm(ks[0], (BATCH, SEQ, D_MODEL), 1.0),
        "x_sample": nrm(ks[1], (DEC_BATCH, DEC_SEQ, D_MODEL), 1.0),
        "norm_mix": 1.0 + nrm(ks[2], (DEPTH, D_MODEL), 0.02),
        "w_in": nrm(ks[3], (DEPTH, D_MODEL, IN_WIDTH), D_MODEL ** -0.5),
        "rel_bias_a": nrm(ks[4], (DEPTH, NA_HEADS, 2 * NA_ROWS - 1, 2 * NA_COLS - 1), 0.1),
        "q_gain_c": 1.0 + nrm(ks[5], (DEPTH, HEAD_DIM), 0.02),
        "k_gain_c": 1.0 + nrm(ks[6], (DEPTH, HEAD_DIM), 0.02),
        "sink_d": nrm(ks[7], (DEPTH, SW_Q_HEADS), 0.5),
        "w_branch_a": nrm(ks[8], (DEPTH, A_W, D_MODEL), A_W ** -0.5),
        "w_branch_b": nrm(ks[9], (DEPTH, B_OUT, D_MODEL), B_OUT ** -0.5),
        "w_branch_c": nrm(ks[10], (DEPTH, C_QW, D_MODEL), C_QW ** -0.5),
        "w_branch_d": nrm(ks[11], (DEPTH, D_QW, D_MODEL), D_QW ** -0.5),
        "w_out": nrm(ks[12], (DEPTH, D_MODEL, D_MODEL), D_MODEL ** -0.5),
        "norm_mlp": 1.0 + nrm(ks[13], (DEPTH, D_MODEL), 0.02),
        "w_up": nrm(ks[14], (DEPTH, D_MODEL, D_FF), D_MODEL ** -0.5),
        "w_down": nrm(ks[15], (DEPTH, D_FF, D_MODEL), D_FF ** -0.5),
        "norm_final": 1.0 + nrm(ks[16], (D_MODEL,), 0.02),
    }


def reference(x_prompt, x_sample, norm_mix, w_in, rel_bias_a, q_gain_c, k_gain_c, sink_d, w_branch_a,
              w_branch_b, w_branch_c, w_branch_d, w_out, norm_mlp, w_up, w_down, norm_final):
    y_prompt = trunk(x_prompt, norm_mix, w_in, rel_bias_a, q_gain_c, k_gain_c, sink_d, w_branch_a, w_branch_b,
                     w_branch_c, w_branch_d, w_out, norm_mlp, w_up, w_down, norm_final)
    y_sample = trunk(x_sample, norm_mix, w_in, rel_bias_a, q_gain_c, k_gain_c, sink_d, w_branch_a, w_branch_b,
                     w_branch_c, w_branch_d, w_out, norm_mlp, w_up, w_down, norm_final)
    return (y_prompt, y_sample)
```

```cpp
#include <hip/hip_runtime.h>
#include <cstdio>
#include <cstdint>

#ifndef PH_EN
#define PH_EN 0x3ff
#endif
#ifndef MK_N_LAUNCHES
#define MK_N_LAUNCHES 0
#endif

#define LAS __attribute__((address_space(3)))
#define GAS __attribute__((address_space(1)))
typedef unsigned short bf16_t;
typedef short bf16x8 __attribute__((ext_vector_type(8)));
typedef short s16x4 __attribute__((ext_vector_type(4)));
typedef float f32x4 __attribute__((ext_vector_type(4)));
typedef float f32x16 __attribute__((ext_vector_type(16)));
typedef unsigned u32x4 __attribute__((ext_vector_type(4)));
typedef unsigned u32x2 __attribute__((ext_vector_type(2)));

constexpr int DM = 2048, MTOK = 24576, MPROMPT = 16384, NIN = 13568, DFF = 8192, DEPTH = 4;
constexpr int PP = NIN;
constexpr int C_AQ = 0, C_AK = 512, C_AV = 1024, C_BQ = 1536, C_BK = 2304, C_BV = 3072, C_CQ = 3840, C_CK = 4352, C_CV = 4480, C_DQ = 4608, C_DK = 5120, C_DV = 5248, C_GT = 5376;
constexpr float RMS_EPS = 1e-6f;
constexpr float LOG2E = 1.4426950408889634f;
constexpr float QSCALE = 0.125f * LOG2E;

constexpr size_t MiB = 1u << 20;
constexpr size_t WS_CTL = 0, CTL_ZERO_BYTES = 1 * MiB;
constexpr size_t WS_W = 1 * MiB, WL_STRIDE = 132 * MiB;
constexpr size_t WL_IN = 0, WL_A = 53 * MiB, WL_B = 55 * MiB, WL_C = 56 * MiB, WL_D = 58 * MiB, WL_OUT = 60 * MiB, WL_UP = 68 * MiB, WL_DN = 100 * MiB;
constexpr size_t WS_H = WS_W + DEPTH * WL_STRIDE;
constexpr size_t WS_P = WS_H + 96 * MiB;
constexpr size_t WS_YA = WS_P + 636 * MiB;
constexpr size_t WS_YB = WS_YA + 24 * MiB;
constexpr size_t WS_YC = WS_YB + 12 * MiB;
constexpr size_t WS_YD = WS_YC + 24 * MiB;
constexpr size_t WS_OB = WS_YD + 24 * MiB;
constexpr size_t WS_LSE = WS_OB + 36 * MiB;
constexpr size_t WS_END = WS_LSE + 2 * MiB;

constexpr int RING_BYTES = 131072;
constexpr int LDSCTL_OFF = RING_BYTES, MISC_OFF = LDSCTL_OFF + 320;
constexpr int LDS_BYTES = 147456;
constexpr int NWAVES = 8;

__device__ __forceinline__ unsigned cvt_pk_bf16(float lo, float hi) { unsigned r; asm volatile("v_cvt_pk_bf16_f32 %0, %1, %2" : "=v"(r) : "v"(lo), "v"(hi)); return r; }
__device__ __forceinline__ unsigned f2bf(float f) { unsigned u = __builtin_bit_cast(unsigned, f); return (u + 0x7fffu + ((u >> 16) & 1u)) >> 16; }
__device__ __forceinline__ unsigned pk2(float lo, float hi) { return f2bf(lo) | (f2bf(hi) << 16); }
__device__ __forceinline__ float bf_lo(unsigned w) { return __uint_as_float(w << 16); }
__device__ __forceinline__ float bf_hi(unsigned w) { return __uint_as_float(w & 0xffff0000u); }
__device__ __forceinline__ float bf2f(bf16_t b) { return __uint_as_float(((unsigned)b) << 16); }
__device__ __forceinline__ float wave_sum(float v) {
#pragma unroll
    for (int o = 1; o < 64; o <<= 1) v += __shfl_xor(v, o);
    return v;
}
#define LDS_WAIT() asm volatile("s_waitcnt lgkmcnt(0)" ::: "memory")
#define VM_WAIT() asm volatile("s_waitcnt vmcnt(0)" ::: "memory")

namespace pg8 {
constexpr int BM = 256, BK = 64, HALF = 128, HTB = HALF * BK * 2, STAGE_BYTES = 8 * HTB, NXCD = 8, WGM = 8;
__host__ __device__ __forceinline__ int lds_byte(int r, int c) { const int st = (r >> 4) * 2 + (c >> 5), rr = r & 15, cc = c & 31, ob = rr * 64 + cc * 2; return st * 1024 + (ob ^ (((ob >> 9) & 1) << 5)); }
__host__ __device__ __forceinline__ void stage_rc(int b, int& R, int& C) { const int st = b / 1024, sb = b % 1024, swz = sb ^ (((sb >> 9) & 1) << 5); R = (st >> 1) * 16 + swz / 64; C = (st & 1) * 32 + (swz % 64) / 2; }
__host__ __device__ __forceinline__ int perm32(int rho) { const int n = rho >> 4, i = rho & 15; return 8 * (i >> 2) + 4 * n + (i & 3); }

struct Unit { int pm, pn, sub; };
struct OpsOne { const bf16_t* A; const bf16_t* B; int K;
    __device__ __forceinline__ void get(int, const char*& a, const char*& b, int& k) const { a = (const char*)A; b = (const char*)B; k = K; } };
struct OpsBranch { const unsigned char* ws; const unsigned char* wl;
    __device__ __forceinline__ void get(int s, const char*& a, const char*& b, int& k) const {
        const size_t ao = s == 0 ? WS_YA : s == 1 ? WS_YB : s == 2 ? WS_YC : WS_YD; const size_t bo = s == 0 ? WL_A : s == 1 ? WL_B : s == 2 ? WL_C : WL_D;
        a = (const char*)(ws + ao); b = (const char*)(wl + bo); k = s == 1 ? 256 : 512; } };
struct StaticOrder {
    int nM, nN, nwg, G, c, lsub;
    __device__ void init(int M, int N, int G_, int c_, int lsub_) { nM = M / BM; nN = N / BM; nwg = nM * nN; G = G_; c = c_; lsub = lsub_; }
    __device__ bool next(int i, Unit& u) const {
        const int ti = i >> lsub; u.sub = i - (ti << lsub);
        const long L = (long)ti * G + c; if (L >= nwg) return false;
        int wgid = (int)L; { const int q = nwg / NXCD, r = nwg % NXCD, xcd = wgid % NXCD, off = wgid / NXCD; wgid = (xcd < r ? xcd * (q + 1) : r * (q + 1) + (xcd - r) * q) + off; }
        const int nig = WGM * nN, gid = wgid / nig, fm = gid * WGM, gsz = (nM - fm) < WGM ? (nM - fm) : WGM;
        u.pm = fm + ((wgid % nig) % gsz); u.pn = (wgid % nig) / gsz; return true;
    }
};

struct EpiInProj {
    static constexpr bool PERM = true;
    bf16_t* O;
    __device__ __forceinline__ void operator()(const f32x4 (&acc)[2][2][4][2], const Unit& u, int wr, int wc, int fr, int fq) const {
        const int row0 = u.pm * BM + wr * 64 + fr, col0 = u.pn * BM + wc * 32 + 8 * fq;
        const int pn = u.pn; const bool gate = pn >= 21; const bool qs = (pn <= 1) || (pn >= 6 && pn <= 8) || (pn == 18) || (pn == 19);
        const float sc = qs ? QSCALE : 1.0f;
#pragma unroll
        for (int ai = 0; ai < 2; ++ai)
#pragma unroll
            for (int m = 0; m < 4; ++m) { bf16_t* rowp = O + (size_t)(row0 + ai * HALF + m * 16) * PP + col0;
#pragma unroll
                for (int bj = 0; bj < 2; ++bj) { f32x4 v0 = acc[ai][bj][m][0], v1 = acc[ai][bj][m][1];
                    if (gate) {
#pragma unroll
                        for (int j = 0; j < 4; ++j) { v0[j] = __builtin_amdgcn_rcpf(1.0f + __builtin_amdgcn_exp2f(-LOG2E * v0[j])); v1[j] = __builtin_amdgcn_rcpf(1.0f + __builtin_amdgcn_exp2f(-LOG2E * v1[j])); }
                    } else { v0 = v0 * sc; v1 = v1 * sc; }
                    u32x4 w; w.x = cvt_pk_bf16(v0[0], v0[1]); w.y = cvt_pk_bf16(v0[2], v0[3]); w.z = cvt_pk_bf16(v1[0], v1[1]); w.w = cvt_pk_bf16(v1[2], v1[3]);
                    *(u32x4*)(rowp + bj * HALF) = w; } }
    }
};
struct EpiRelu2 {
    static constexpr bool PERM = true;
    bf16_t* O; int ldc;
    __device__ __forceinline__ void operator()(const f32x4 (&acc)[2][2][4][2], const Unit& u, int wr, int wc, int fr, int fq) const {
        const int row0 = u.pm * BM + wr * 64 + fr, col0 = u.pn * BM + wc * 32 + 8 * fq;
#pragma unroll
        for (int ai = 0; ai < 2; ++ai)
#pragma unroll
            for (int m = 0; m < 4; ++m) { bf16_t* rowp = O + (size_t)(row0 + ai * HALF + m * 16) * ldc + col0;
#pragma unroll
                for (int bj = 0; bj < 2; ++bj) { f32x4 v0 = acc[ai][bj][m][0], v1 = acc[ai][bj][m][1];
#pragma unroll
                    for (int j = 0; j < 4; ++j) { const float a = fmaxf(v0[j], 0.f), b = fmaxf(v1[j], 0.f); v0[j] = a * a; v1[j] = b * b; }
                    u32x4 w; w.x = cvt_pk_bf16(v0[0], v0[1]); w.y = cvt_pk_bf16(v0[2], v0[3]); w.z = cvt_pk_bf16(v1[0], v1[1]); w.w = cvt_pk_bf16(v1[2], v1[3]);
                    *(u32x4*)(rowp + bj * HALF) = w; } }
    }
};
struct EpiGated {
    static constexpr bool PERM = true;
    bf16_t* O; const bf16_t* P;
    __device__ __forceinline__ void operator()(const f32x4 (&acc)[2][2][4][2], const Unit& u, int wr, int wc, int fr, int fq) const {
        const int row0 = u.pm * BM + wr * 64 + fr, col0 = u.pn * BM + wc * 32 + 8 * fq; const int s = u.sub;
#pragma unroll
        for (int ai = 0; ai < 2; ++ai)
#pragma unroll
            for (int m = 0; m < 4; ++m) { const size_t row = (size_t)(row0 + ai * HALF + m * 16);
                bf16_t* rowp = O + row * DM + col0; const bf16_t* gp = P + row * PP + C_GT + s * DM + col0;
#pragma unroll
                for (int bj = 0; bj < 2; ++bj) { const f32x4 v0 = acc[ai][bj][m][0], v1 = acc[ai][bj][m][1];
                    const u32x4 g = *(const u32x4*)(gp + bj * HALF);
                    float r[8];
                    r[0] = v0[0] * bf_lo(g.x); r[1] = v0[1] * bf_hi(g.x); r[2] = v0[2] * bf_lo(g.y); r[3] = v0[3] * bf_hi(g.y);
                    r[4] = v1[0] * bf_lo(g.z); r[5] = v1[1] * bf_hi(g.z); r[6] = v1[2] * bf_lo(g.w); r[7] = v1[3] * bf_hi(g.w);
                    if (s != 0) { const u32x4 p = *(const u32x4*)(rowp + bj * HALF);
                        r[0] += bf_lo(p.x); r[1] += bf_hi(p.x); r[2] += bf_lo(p.y); r[3] += bf_hi(p.y); r[4] += bf_lo(p.z); r[5] += bf_hi(p.z); r[6] += bf_lo(p.w); r[7] += bf_hi(p.w); }
                    u32x4 w; w.x = cvt_pk_bf16(r[0], r[1]); w.y = cvt_pk_bf16(r[2], r[3]); w.z = cvt_pk_bf16(r[4], r[5]); w.w = cvt_pk_bf16(r[6], r[7]);
                    *(u32x4*)(rowp + bj * HALF) = w; }
                asm volatile("" ::: "memory"); }
    }
};
struct EpiResid {
    static constexpr bool PERM = false;
    const float* base_p; const float* base_s; float* out;
    __device__ __forceinline__ void operator()(const f32x4 (&acc)[2][2][4][2], const Unit& u, int wr, int wc, int fr, int fq) const {
        const int row0 = u.pm * BM + wr * 64 + fr, col0 = u.pn * BM + wc * 32 + 4 * fq;
        const bool pr = (u.pm * BM) < MPROMPT; const float* base = pr ? base_p : (base_s - (size_t)MPROMPT * DM);
#pragma unroll
        for (int ai = 0; ai < 2; ++ai)
#pragma unroll
            for (int m = 0; m < 4; ++m) { const size_t off = (size_t)(row0 + ai * HALF + m * 16) * DM + col0;
#pragma unroll
                for (int bj = 0; bj < 2; ++bj)
#pragma unroll
                    for (int n = 0; n < 2; ++n) { const f32x4 bs = *(const f32x4*)(base + off + bj * HALF + n * 16); *(f32x4*)(out + off + bj * HALF + n * 16) = bs + acc[ai][bj][m][n]; }
                asm volatile("" ::: "memory"); }
    }
};

template <class Epi, class Ops>
__device__ __forceinline__ void gemm_phase(LAS unsigned char* lds, const Ops& g, const StaticOrder& S, const Epi& E) {
    int tid = threadIdx.x; asm volatile("" : "+v"(tid));
    const int wid = __builtin_amdgcn_readfirstlane(tid >> 6), lane = tid & 63, wr = wid >> 2, wc = wid & 3, fr = lane & 15, fq = lane >> 4;
    unsigned rA[2], rB[2], cB2[2];
#pragma unroll
    for (int i = 0; i < 2; ++i) { int R, C; stage_rc(tid * 16 + i * 8192, R, C); rA[i] = (unsigned)R; rB[i] = (unsigned)(Epi::PERM ? ((R & ~31) + perm32(R & 31)) : R); cB2[i] = (unsigned)C * 2u; }
    const size_t kstep = (size_t)(BK * 2);
    const unsigned ldsw = (unsigned)wid * 1024u;
    const int aoff = lds_byte(wr * 64 + fr, fq * 8), boff = lds_byte(wc * 32 + fr, fq * 8);
#define PG8_SA(b, h) (((b) * 2 + (h)) * HTB)
#define PG8_SB(b, h) ((4 + (b) * 2 + (h)) * HTB)
#define PG8_STAGE(bufoff, gbase, rr, K2) do { _Pragma("unroll") for (int _i = 0; _i < 2; ++_i) \
        __builtin_amdgcn_global_load_lds((const unsigned*)((const char*)(gbase) + ((rr)[_i] * (unsigned)(K2) + cB2[_i])), (LAS unsigned*)(lds + (bufoff) + ldsw + _i * 8192), 16, 0, 0); } while (0)
#define PG8_LDA(dst, b, h) do { _Pragma("unroll") for (int m = 0; m < 4; ++m) _Pragma("unroll") for (int k = 0; k < 2; ++k) dst[m][k] = *(const LAS bf16x8*)(lds + PG8_SA(b, h) + aoff + m * 2048 + k * 1024); } while (0)
#define PG8_LDB(dst, b, h) do { _Pragma("unroll") for (int n = 0; n < 2; ++n) _Pragma("unroll") for (int k = 0; k < 2; ++k) dst[n][k] = *(const LAS bf16x8*)(lds + PG8_SB(b, h) + boff + n * 2048 + k * 1024); } while (0)
#define PG8_MMA(ai, bj, At, Bt) do { __builtin_amdgcn_s_setprio(1); _Pragma("unroll") for (int m = 0; m < 4; ++m) _Pragma("unroll") for (int n = 0; n < 2; ++n) _Pragma("unroll") for (int k = 0; k < 2; ++k) \
        acc[ai][bj][m][n] = __builtin_amdgcn_mfma_f32_16x16x32_bf16(Bt[n][k], At[m][k], acc[ai][bj][m][n], 0, 0, 0); __builtin_amdgcn_s_setprio(0); } while (0)
#define PG8_WAIT_V(n) asm volatile("s_waitcnt vmcnt(" #n ")" ::: "memory")
#define PG8_WAIT_L(n) asm volatile("s_waitcnt lgkmcnt(" #n ")" ::: "memory")
#define PG8_BAR __builtin_amdgcn_s_barrier()
#define PG8_SCHED __builtin_amdgcn_sched_barrier(0)
    Unit cur, nxt; int ui = 0;
    if (!S.next(0, cur)) return;
    f32x4 acc[2][2][4][2];
#pragma unroll
    for (int a = 0; a < 2; ++a)
#pragma unroll
        for (int b = 0; b < 2; ++b)
#pragma unroll
            for (int m = 0; m < 4; ++m)
#pragma unroll
                for (int n = 0; n < 2; ++n) acc[a][b][m][n] = (f32x4){0.f, 0.f, 0.f, 0.f};
    bf16x8 At[4][2], B0[2][2], B1[2][2];
    const char* pA; const char* pB; int cK; g.get(cur.sub, pA, pB, cK);
    int cK2 = cK * 2;
    size_t hstep = (size_t)HALF * cK2;
    const char* cA = pA + (size_t)cur.pm * 2 * hstep; const char* cB = pB + (size_t)cur.pn * 2 * hstep;
    PG8_STAGE(PG8_SB(0, 0), cB, rB, cK2); PG8_STAGE(PG8_SB(0, 1), cB + hstep, rB, cK2); PG8_STAGE(PG8_SA(0, 0), cA, rA, cK2); PG8_STAGE(PG8_SA(0, 1), cA + hstep, rA, cK2);
    if (wr == 1) PG8_BAR;
    PG8_WAIT_V(2); PG8_BAR;
    PG8_STAGE(PG8_SB(1, 0), cB + kstep, rB, cK2); PG8_STAGE(PG8_SA(1, 0), cA + kstep, rA, cK2); PG8_STAGE(PG8_SB(1, 1), cB + hstep + kstep, rB, cK2);
    PG8_WAIT_V(6); PG8_BAR;
    for (;;) {
        const bool has_next = S.next(ui + 1, nxt);
        const char* qA; const char* qB; int nK; g.get(has_next ? nxt.sub : cur.sub, qA, qB, nK);
        const int nK2 = nK * 2; const size_t nhstep = (size_t)HALF * nK2;
        const char* nA = has_next ? qA + (size_t)nxt.pm * 2 * nhstep : cA; const char* nB = has_next ? qB + (size_t)nxt.pn * 2 * nhstep : cB;
        const int nt = cK / BK;
        for (int t = 0; t < nt; t += 2) {
            const bool last = (t == nt - 2);
            const char* a1 = cA + (size_t)(t + 1) * kstep;
            const char* a2 = last ? nA : cA + (size_t)(t + 2) * kstep; const char* b2 = last ? nB : cB + (size_t)(t + 2) * kstep;
            const char* a3 = a2 + kstep; const char* b3 = b2 + kstep;
            const size_t h2 = last ? nhstep : hstep;
            const int k2 = last ? nK2 : cK2;
            PG8_LDB(B0, 0, 0); PG8_LDB(B1, 0, 1); PG8_SCHED; PG8_LDA(At, 0, 0); PG8_STAGE(PG8_SA(1, 1), a1 + hstep, rA, cK2);
            PG8_WAIT_V(8); PG8_WAIT_L(0); PG8_BAR; PG8_MMA(0, 0, At, B0); PG8_MMA(0, 1, At, B1); PG8_BAR; PG8_SCHED;
            PG8_LDA(At, 0, 1); PG8_STAGE(PG8_SB(0, 0), b2, rB, k2); PG8_STAGE(PG8_SB(0, 1), b2 + h2, rB, k2); PG8_STAGE(PG8_SA(0, 0), a2, rA, k2);
            PG8_WAIT_V(8); PG8_WAIT_L(0); PG8_BAR; PG8_MMA(1, 0, At, B0); PG8_MMA(1, 1, At, B1); PG8_BAR; PG8_SCHED;
            PG8_LDB(B0, 1, 0); PG8_LDB(B1, 1, 1); PG8_SCHED; PG8_LDA(At, 1, 0); PG8_STAGE(PG8_SA(0, 1), a2 + h2, rA, k2);
            PG8_WAIT_V(8); PG8_WAIT_L(0); PG8_BAR; PG8_MMA(0, 0, At, B0); PG8_MMA(0, 1, At, B1); PG8_BAR; PG8_SCHED;
            PG8_LDA(At, 1, 1); PG8_STAGE(PG8_SB(1, 0), b3, rB, k2); PG8_STAGE(PG8_SB(1, 1), b3 + h2, rB, k2); PG8_STAGE(PG8_SA(1, 0), a3, rA, k2);
            PG8_WAIT_V(8); PG8_WAIT_L(0); PG8_BAR; PG8_MMA(1, 0, At, B0); PG8_MMA(1, 1, At, B1); PG8_BAR; PG8_SCHED;
        }
        if (wr == 0) PG8_BAR;
        E(acc, cur, wr, wc, fr, fq);
        if (!has_next) break;
#pragma unroll
        for (int a = 0; a < 2; ++a)
#pragma unroll
            for (int b = 0; b < 2; ++b)
#pragma unroll
                for (int m = 0; m < 4; ++m)
#pragma unroll
                    for (int n = 0; n < 2; ++n) acc[a][b][m][n] = (f32x4){0.f, 0.f, 0.f, 0.f};
        cur = nxt; cA = nA; cB = nB; cK = nK; cK2 = nK2; hstep = nhstep; ++ui;
        if (wr == 1) PG8_BAR;
    }
    PG8_WAIT_V(0);
    PG8_BAR;
#undef PG8_SA
#undef PG8_SB
#undef PG8_STAGE
#undef PG8_LDA
#undef PG8_LDB
#undef PG8_MMA
#undef PG8_WAIT_V
#undef PG8_WAIT_L
#undef PG8_BAR
#undef PG8_SCHED
}
}

namespace att {
typedef LAS const char* lcp;
constexpr int SLOTB = 8192, K_OFF = 0, V_OFF = 3 * SLOTB, TBL_OFF = 6 * SLOTB;
__device__ __forceinline__ int crow(int r, int hi) { return (r & 3) + 8 * (r >> 2) + 4 * hi; }
__device__ __forceinline__ void glds16(const void* gsrc, unsigned lds_dst) { unsigned keep;
    asm volatile("s_mov_b32 %0, m0\n\ts_mov_b32 m0, %2\n\ts_nop 0\n\tglobal_load_lds_dwordx4 %1, off\n\ts_mov_b32 m0, %0" : "=&s"(keep) : "v"(gsrc), "s"(lds_dst) : "memory"); }
#define ATT_WAIT_BAR(N) asm volatile("s_waitcnt vmcnt(" #N ") lgkmcnt(0)\n\ts_barrier" ::: "memory")
typedef short v4i16_t __attribute__((ext_vector_type(4)));
__device__ __forceinline__ s16x4 vtr(lcp p) { return __builtin_bit_cast(s16x4, __builtin_amdgcn_ds_read_tr16_b64_v4i16((LAS v4i16_t*)p)); }
__device__ __forceinline__ float xmax(float a) { auto rr = __builtin_amdgcn_permlane32_swap(__float_as_uint(a), __float_as_uint(a), false, false); return fmaxf(__uint_as_float(rr[0]), __uint_as_float(rr[1])); }
__device__ __forceinline__ float xsum(float a) { auto rr = __builtin_amdgcn_permlane32_swap(__float_as_uint(a), __float_as_uint(a), false, false); return __uint_as_float(rr[0]) + __uint_as_float(rr[1]); }

template <class TR>
__device__ __forceinline__ void attn_unit(const TR& tr, LAS char* shm) {
    int tid = threadIdx.x; asm volatile("" : "+v"(tid));
    const int lane = tid & 63, r32 = lane & 31, hi = lane >> 5; const int wid = __builtin_amdgcn_readfirstlane(tid >> 6);
    const unsigned lds0 = (unsigned)(uintptr_t)shm;
    bf16x8 qr[4];
    { const bf16_t* qp = tr.qrow(wid, r32);
#pragma unroll
      for (int d0 = 0; d0 < 4; ++d0) qr[d0] = *(const bf16x8*)(qp + d0 * 16 + hi * 8); }
    float m = tr.m_init(wid), l = (hi == 0) ? tr.l_init(wid) : 0.f;
    f32x16 o0 = {}, o1 = {};
    const int T0 = tr.t0, T1 = tr.t1;
#define ATT_DMA(t, slot) do { \
        const bf16_t* kp_ = tr.krow((t), lane) + wid * 8; \
        const bf16_t* vp_ = tr.vrow((t), 16 * (wid & 3) + (lane >> 2)) + (wid >> 2) * 32 + (lane & 3) * 8; \
        glds16(kp_, (unsigned)__builtin_amdgcn_readfirstlane(lds0 + K_OFF + (slot) * SLOTB + wid * 1024)); \
        glds16(vp_, (unsigned)__builtin_amdgcn_readfirstlane(lds0 + V_OFF + (slot) * SLOTB + wid * 1024)); } while (0)
    if (T0 < T1) ATT_DMA(T0, 0);
    if (T0 + 1 < T1) ATT_DMA(T0 + 1, 1);
    int slot = 0;
    const lcp kbase = (lcp)shm + K_OFF + hi * 1024 + r32 * 16;
    const lcp vbase = (lcp)shm + V_OFF + ((lane >> 4) & 1) * 32 + (lane & 3) * 8 + (4 * hi + ((lane & 15) >> 2)) * 64;
    for (int t = T0; t < T1; ++t) {
        if (t + 1 < T1) { ATT_WAIT_BAR(2); } else { ATT_WAIT_BAR(0); }
        if (t + 2 < T1) { const int s2 = slot >= 1 ? slot - 1 : 2; ATT_DMA(t + 2, s2); }
        if (tr.used(t, wid)) {
            const lcp kb = kbase + slot * SLOTB; const lcp vb = vbase + slot * SLOTB;
            f32x16 p0 = {}, p1 = {};
#pragma unroll
            for (int d0 = 0; d0 < 4; ++d0) {
                const bf16x8 b0 = *(const LAS bf16x8*)(kb + d0 * 2048);
                const bf16x8 b1 = *(const LAS bf16x8*)(kb + d0 * 2048 + 512);
                p0 = __builtin_amdgcn_mfma_f32_32x32x16_bf16(b0, qr[d0], p0, 0, 0, 0);
                p1 = __builtin_amdgcn_mfma_f32_32x32x16_bf16(b1, qr[d0], p1, 0, 0, 0);
            }
            tr.mask(p0, p1, t, wid, r32, hi);
            float rm = fmaxf(p0[0], p1[0]);
#pragma unroll
            for (int r = 1; r < 16; ++r) rm = fmaxf(rm, fmaxf(p0[r], p1[r]));
            rm = xmax(rm);
            const float mnew = fmaxf(m, rm); const float f = __builtin_amdgcn_exp2f(m - mnew); m = mnew;
            float ls = 0.f;
#pragma unroll
            for (int r = 0; r < 16; ++r) { p0[r] = __builtin_amdgcn_exp2f(p0[r] - mnew); p1[r] = __builtin_amdgcn_exp2f(p1[r] - mnew); ls += p0[r] + p1[r]; }
            l = l * f + ls;
#pragma unroll
            for (int r = 0; r < 16; ++r) { o0[r] *= f; o1[r] *= f; }
            u32x4 pw[4];
#pragma unroll
            for (int k = 0; k < 2; ++k) {
                pw[k] = (u32x4){cvt_pk_bf16(p0[8 * k + 0], p0[8 * k + 1]), cvt_pk_bf16(p0[8 * k + 2], p0[8 * k + 3]), cvt_pk_bf16(p0[8 * k + 4], p0[8 * k + 5]), cvt_pk_bf16(p0[8 * k + 6], p0[8 * k + 7])};
                pw[2 + k] = (u32x4){cvt_pk_bf16(p1[8 * k + 0], p1[8 * k + 1]), cvt_pk_bf16(p1[8 * k + 2], p1[8 * k + 3]), cvt_pk_bf16(p1[8 * k + 4], p1[8 * k + 5]), cvt_pk_bf16(p1[8 * k + 6], p1[8 * k + 7])};
            }
#pragma unroll
            for (int ks = 0; ks < 4; ++ks) {
                const s16x4 l0 = vtr(vb + ks * 1024), h0 = vtr(vb + ks * 1024 + 512);
                const s16x4 l1 = vtr(vb + 4096 + ks * 1024), h1 = vtr(vb + 4096 + ks * 1024 + 512);
                const bf16x8 v0 = (bf16x8){l0[0], l0[1], l0[2], l0[3], h0[0], h0[1], h0[2], h0[3]};
                const bf16x8 v1 = (bf16x8){l1[0], l1[1], l1[2], l1[3], h1[0], h1[1], h1[2], h1[3]};
                const bf16x8 pa = __builtin_bit_cast(bf16x8, pw[ks]);
                o0 = __builtin_amdgcn_mfma_f32_32x32x16_bf16(v0, pa, o0, 0, 0, 0);
                o1 = __builtin_amdgcn_mfma_f32_32x32x16_bf16(v1, pa, o1, 0, 0, 0);
            }
        }
        slot = slot == 2 ? 0 : slot + 1;
    }
    l = xsum(l);
    tr.store(o0, o1, m, l, wid, r32, hi);
    asm volatile("s_waitcnt lgkmcnt(0)\n\ts_barrier" ::: "memory");
#undef ATT_DMA
}
__device__ __forceinline__ void store_row_bf16(bf16_t* dst, const f32x16& o0, const f32x16& o1, float s, int hi) {
#pragma unroll
    for (int g4 = 0; g4 < 4; ++g4) {
        u32x2 w0, w1;
        w0.x = cvt_pk_bf16(o0[4 * g4 + 0] * s, o0[4 * g4 + 1] * s); w0.y = cvt_pk_bf16(o0[4 * g4 + 2] * s, o0[4 * g4 + 3] * s);
        w1.x = cvt_pk_bf16(o1[4 * g4 + 0] * s, o1[4 * g4 + 1] * s); w1.y = cvt_pk_bf16(o1[4 * g4 + 2] * s, o1[4 * g4 + 3] * s);
        *(u32x2*)(dst + 8 * g4 + 4 * hi) = w0;
        *(u32x2*)(dst + 32 + 8 * g4 + 4 * hi) = w1;
    }
}
constexpr float NEG_INF = -__builtin_inff();
constexpr float M_INIT = -1.0e30f;

struct TrA {
    int t0, t1; int rb, R; const bf16_t* Pq; const bf16_t* Pk; const bf16_t* Pv; bf16_t* Y; LAS const float* tbl;
    __device__ __forceinline__ int r0w(int wid) const { const int r = 4 * rb + (wid >> 1); const int a = r - 4; return a < 0 ? 0 : (a > R - 8 ? R - 8 : a); }
    __device__ __forceinline__ const bf16_t* qrow(int wid, int r32) const { return Pq + (size_t)((4 * rb + (wid >> 1)) * 64 + 32 * (wid & 1) + r32) * PP; }
    __device__ __forceinline__ const bf16_t* krow(int t, int j) const { return Pk + (size_t)(t * 64 + j) * PP; }
    __device__ __forceinline__ const bf16_t* vrow(int t, int j) const { return Pv + (size_t)(t * 64 + j) * PP; }
    __device__ __forceinline__ bool used(int t, int wid) const { const int a = r0w(wid); return t >= a && t < a + 8; }
    __device__ __forceinline__ void mask(f32x16& p0, f32x16& p1, int t, int wid, int r32, int hi) const {
        const int r = 4 * rb + (wid >> 1), qc = 32 * (wid & 1) + r32; const int c0 = qc - 8 < 0 ? 0 : (qc - 8 > 48 ? 48 : qc - 8);
        const int dr = t - r + 7; LAS const float* tb = tbl + dr * 31 + 15 - qc;
#pragma unroll
        for (int rr = 0; rr < 16; ++rr) {
            const int k0 = crow(rr, hi), k1 = k0 + 32;
            const bool v0 = (unsigned)(k0 - c0) < 16u, v1 = (unsigned)(k1 - c0) < 16u;
            const float b0 = tb[v0 ? k0 : qc], b1 = tb[v1 ? k1 : qc];
            p0[rr] = v0 ? p0[rr] + b0 : NEG_INF; p1[rr] = v1 ? p1[rr] + b1 : NEG_INF;
        }
    }
    __device__ __forceinline__ float m_init(int) const { return M_INIT; }
    __device__ __forceinline__ float l_init(int) const { return 0.f; }
    __device__ __forceinline__ void store(const f32x16& o0, const f32x16& o1, float m, float l, int wid, int r32, int hi) const {
        bf16_t* dst = Y + (size_t)((4 * rb + (wid >> 1)) * 64 + 32 * (wid & 1) + r32) * 512;
        store_row_bf16(dst, o0, o1, __builtin_amdgcn_rcpf(l), hi);
    }
};
struct TrB {
    int t0, t1; int fb, n, d, res; float slope2;
    const bf16_t* Pq; const bf16_t* Pk; const bf16_t* Pv; bf16_t* O; float* LSE;
    __device__ __forceinline__ int tok(int mf) const { const int c = mf < 0 ? 0 : (mf > n - 1 ? n - 1 : mf); return c * d + res; }
    __device__ __forceinline__ const bf16_t* qrow(int wid, int r32) const { return Pq + (size_t)tok(256 * fb + 32 * wid + r32) * PP; }
    __device__ __forceinline__ const bf16_t* krow(int t, int j) const { return Pk + (size_t)tok(256 * fb - 64 + 64 * t + j) * PP; }
    __device__ __forceinline__ const bf16_t* vrow(int t, int j) const { return Pv + (size_t)tok(256 * fb - 64 + 64 * t + j) * PP; }
    __device__ __forceinline__ bool used(int t, int wid) const { return (64 * t + 63 >= 32 * wid) && (64 * t <= 32 * wid + 159); }
    __device__ __forceinline__ void mask(f32x16& p0, f32x16& p1, int t, int wid, int r32, int hi) const {
        const int mq = 256 * fb + 32 * wid + r32; const int kb = 256 * fb - 64 + 64 * t;
#pragma unroll
        for (int rr = 0; rr < 16; ++rr) {
            const int k0 = kb + crow(rr, hi), k1 = k0 + 32;
            const int d0 = k0 - mq, d1 = k1 - mq; const int a0 = d0 < 0 ? -d0 : d0, a1 = d1 < 0 ? -d1 : d1;
            const bool v0 = a0 <= 64 && (unsigned)k0 < (unsigned)n, v1 = a1 <= 64 && (unsigned)k1 < (unsigned)n;
            p0[rr] = v0 ? p0[rr] - slope2 * (float)a0 : NEG_INF; p1[rr] = v1 ? p1[rr] - slope2 * (float)a1 : NEG_INF;
        }
    }
    __device__ __forceinline__ float m_init(int) const { return M_INIT; }
    __device__ __forceinline__ float l_init(int) const { return 0.f; }
    __device__ __forceinline__ void store(const f32x16& o0, const f32x16& o1, float m, float l, int wid, int r32, int hi) const {
        const int mq = 256 * fb + 32 * wid + r32;
        if (mq < n) { const size_t row = (size_t)(mq * d + res);
            store_row_bf16(O + row * 256, o0, o1, __builtin_amdgcn_rcpf(l), hi);
            if (hi == 0) LSE[row * 4] = m + __builtin_amdgcn_logf(l); }
    }
};
struct TrC {
    int t0, t1; int qb; const bf16_t* Pq; const bf16_t* Pk; const bf16_t* Pv; bf16_t* Y;
    __device__ __forceinline__ const bf16_t* qrow(int wid, int r32) const { return Pq + (size_t)(256 * qb + 32 * wid + r32) * PP; }
    __device__ __forceinline__ const bf16_t* krow(int t, int j) const { return Pk + (size_t)(t * 64 + j) * PP; }
    __device__ __forceinline__ const bf16_t* vrow(int t, int j) const { return Pv + (size_t)(t * 64 + j) * PP; }
    __device__ __forceinline__ bool used(int, int) const { return true; }
    __device__ __forceinline__ void mask(f32x16&, f32x16&, int, int, int, int) const {}
    __device__ __forceinline__ float m_init(int) const { return M_INIT; }
    __device__ __forceinline__ float l_init(int) const { return 0.f; }
    __device__ __forceinline__ void store(const f32x16& o0, const f32x16& o1, float m, float l, int wid, int r32, int hi) const {
        store_row_bf16(Y + (size_t)(256 * qb + 32 * wid + r32) * 512, o0, o1, __builtin_amdgcn_rcpf(l), hi);
    }
};
struct TrD {
    int t0, t1; int qb, L, kvh; const bf16_t* Pq; const bf16_t* Pk; const bf16_t* Pv; bf16_t* Y; const float* sink;
    __device__ __forceinline__ const bf16_t* qrow(int wid, int r32) const { return Pq + (size_t)(64 * qb + 32 * (wid & 1) + r32) * PP + (wid >> 1) * 64; }
    __device__ __forceinline__ int kpos(int t, int j) const { const int p = 64 * (qb - 2 + t) + j; return p < 0 ? 0 : (p > L - 1 ? L - 1 : p); }
    __device__ __forceinline__ const bf16_t* krow(int t, int j) const { return Pk + (size_t)kpos(t, j) * PP; }
    __device__ __forceinline__ const bf16_t* vrow(int t, int j) const { return Pv + (size_t)kpos(t, j) * PP; }
    __device__ __forceinline__ bool used(int, int) const { return true; }
    __device__ __forceinline__ void mask(f32x16& p0, f32x16& p1, int t, int wid, int r32, int hi) const {
        const int q = 64 * qb + 32 * (wid & 1) + r32; const int kb = 64 * (qb - 2 + t);
        const float sl = __builtin_amdgcn_exp2f(-(float)(4 * kvh + (wid >> 1) + 1)) * LOG2E;
#pragma unroll
        for (int rr = 0; rr < 16; ++rr) {
            const int k0 = kb + crow(rr, hi), k1 = k0 + 32;
            const int d0 = k0 - q, d1 = k1 - q; const int a0 = d0 < 0 ? -d0 : d0, a1 = d1 < 0 ? -d1 : d1;
            const bool v0 = a0 <= 128 && (unsigned)k0 < (unsigned)L, v1 = a1 <= 128 && (unsigned)k1 < (unsigned)L;
            p0[rr] = v0 ? p0[rr] - sl * (float)a0 : NEG_INF; p1[rr] = v1 ? p1[rr] - sl * (float)a1 : NEG_INF;
        }
    }
    __device__ __forceinline__ float m_init(int wid) const { return sink[wid >> 1] * LOG2E; }
    __device__ __forceinline__ float l_init(int) const { return 1.f; }
    __device__ __forceinline__ void store(const f32x16& o0, const f32x16& o1, float m, float l, int wid, int r32, int hi) const {
        store_row_bf16(Y + (size_t)(64 * qb + 32 * (wid & 1) + r32) * 512 + (wid >> 1) * 64, o0, o1, __builtin_amdgcn_rcpf(l), hi);
    }
};
}

#define XB_TMO      128
#define XB_XCNT(j)  (256  + 64 * (j))
#define XB_XSUB(j)  (1280 + 64 * (j))
#define XB_XGEN(j)  (2304 + 64 * (j))
#define XB_TOP      3328
#define XB_TOPGEN   3392
#define XCD_BAR_WORDS 3456
#define XB_SPIN_CAP (1u << 18)
__device__ __forceinline__ unsigned xb_ld(unsigned* p)              { return __hip_atomic_load(p, __ATOMIC_RELAXED, __HIP_MEMORY_SCOPE_AGENT); }
__device__ __forceinline__ unsigned xb_add(unsigned* p, unsigned v) { return __hip_atomic_fetch_add(p, v, __ATOMIC_RELAXED, __HIP_MEMORY_SCOPE_AGENT); }
__device__ __forceinline__ unsigned xb_xcc_id() { return (unsigned)__builtin_amdgcn_s_getreg((3 << 11) | 20) & 0xFu; }
#define XB_SPIN(cond, bar) do { unsigned _sp = 0; while (cond) { __builtin_amdgcn_s_sleep(1); \
    if ((++_sp & 255u) == 0u) { if (xb_ld(&(bar)[XB_TMO])) break; if (_sp > XB_SPIN_CAP) { atomicAdd(&(bar)[XB_TMO], 1u); break; } } } } while (0)
struct XcdBarrier { unsigned* bar; unsigned x; volatile LAS unsigned* st; };
__device__ __forceinline__ XcdBarrier xcd_barrier_post(unsigned* bar, volatile LAS unsigned* st) {
    XcdBarrier b; b.bar = bar; b.x = xb_xcc_id(); b.st = st;
    if (threadIdx.x == 0) (void)xb_add(&bar[XB_XCNT(b.x)], 1u);
    return b;
}
__device__ __forceinline__ void xcd_barrier_complete(unsigned* bar, unsigned x, unsigned& nloc, unsigned& nx) {
    const unsigned G = gridDim.x * gridDim.y * gridDim.z;
    unsigned sum, cnt, mine, sp = 0u;
    for (;;) {
        sum = 0u; cnt = 0u; mine = 0u;
#pragma unroll
        for (unsigned j = 0; j < 16; ++j) { const unsigned c = xb_ld(&bar[XB_XCNT(j)]); sum += c; cnt += (c > 0u) ? 1u : 0u; mine = (j == x) ? c : mine; }
        if (sum == G) break;
        __builtin_amdgcn_s_sleep(1);
        if ((++sp & 255u) == 0u) { if (xb_ld(&bar[XB_TMO])) break; if (sp > XB_SPIN_CAP) { atomicAdd(&bar[XB_TMO], 1u); break; } }
    }
    nloc = mine > 0u ? mine : 1u; nx = cnt > 0u ? cnt : 1u;
}
__device__ __forceinline__ void xcd_barrier(const XcdBarrier& b) {
    asm volatile("s_waitcnt vmcnt(0)" ::: "memory");
    __syncthreads();
    if (threadIdx.x == 0) {
        unsigned* bar = b.bar;
        __builtin_amdgcn_s_waitcnt(0);
        unsigned nloc = b.st[0], nx = b.st[1];
        if (nloc == 0u) { xcd_barrier_complete(bar, b.x, nloc, nx); b.st[0] = nloc; b.st[1] = nx; }
        const unsigned old = xb_add(&bar[XB_XSUB(b.x)], 1u);
        const unsigned gen = old / nloc;
        if (old + 1u == (gen + 1u) * nloc) {
            __builtin_amdgcn_fence(__ATOMIC_RELEASE, "agent");
            asm volatile("s_waitcnt vmcnt(0)" ::: "memory");
            const unsigned og = xb_add(&bar[XB_TOP], 1u);
            const unsigned tg = og / nx;
            if (og + 1u == (tg + 1u) * nx) xb_add(&bar[XB_TOPGEN], 1u);
            else XB_SPIN(xb_ld(&bar[XB_TOPGEN]) == tg, bar);
            __builtin_amdgcn_fence(__ATOMIC_ACQUIRE, "agent");
            xb_add(&bar[XB_XGEN(b.x)], 1u);
            asm volatile("s_waitcnt vmcnt(0)" ::: "memory");
        } else {
            XB_SPIN(xb_ld(&bar[XB_XGEN(b.x)]) == gen, bar);
            __builtin_amdgcn_fence(__ATOMIC_ACQUIRE, "agent");
            asm volatile("s_waitcnt vmcnt(0)" ::: "memory");
        }
    }
    __syncthreads();
}

struct Args {
    const float* xp; const float* xs; const float* norm_mix; const float* w_in; const float* rel_bias; const float* qg; const float* kg; const float* sink;
    const float* wa; const float* wb; const float* wc; const float* wd; const float* wout; const float* norm_mlp; const float* wup; const float* wdn; const float* norm_final;
    float* out; unsigned char* ws; int ph_lo, ph_hi;
};

__device__ __forceinline__ void transpose_item(const float* W, int K, int N, bf16_t* WT, LAS float* scr, int item, int lane) {
    const int nblk = N / 32, kb = item / nblk, nb = item % nblk, k0 = 64 * kb, n0 = 32 * nb;
#pragma unroll 8
    for (int i = 0; i < 32; ++i) { const int kk = 2 * i + (lane >> 5); scr[kk * 33 + (lane & 31)] = W[(size_t)(k0 + kk) * N + n0 + (lane & 31)]; }
    LDS_WAIT(); asm volatile("" ::: "memory");
    const int c = lane & 7;
#pragma unroll
    for (int j = 0; j < 4; ++j) { const int n = (lane >> 3) + 8 * j; const LAS float* s = scr + (8 * c) * 33 + n;
        u32x4 o; o.x = pk2(s[0 * 33], s[1 * 33]); o.y = pk2(s[2 * 33], s[3 * 33]); o.z = pk2(s[4 * 33], s[5 * 33]); o.w = pk2(s[6 * 33], s[7 * 33]);
        *(u32x4*)(WT + (size_t)(n0 + n) * K + k0 + 8 * c) = o; }
    LDS_WAIT(); asm volatile("" ::: "memory");
}
__device__ __forceinline__ void norm_phase(const float* src_p, const float* src_s, const float* g, bf16_t* H, int gw, int ngw, int lane) {
    f32x4 gv[8];
#pragma unroll
    for (int j = 0; j < 8; ++j) gv[j] = *((const f32x4*)g + lane + 64 * j);
    for (int row = gw; row < MTOK; row += ngw) {
        const float* xr = row < MPROMPT ? src_p + (size_t)row * DM : src_s + (size_t)(row - MPROMPT) * DM;
        f32x4 v[8]; float s = 0.f;
#pragma unroll
        for (int j = 0; j < 8; ++j) { v[j] = *((const f32x4*)xr + lane + 64 * j); s += (v[j].x * v[j].x + v[j].y * v[j].y) + (v[j].z * v[j].z + v[j].w * v[j].w); }
        const float rstd = 1.0f / sqrtf(wave_sum(s) * (1.0f / DM) + RMS_EPS);
        u32x2* o8 = (u32x2*)(H + (size_t)row * DM) + lane;
#pragma unroll
        for (int j = 0; j < 8; ++j) { u32x2 w; w.x = cvt_pk_bf16(v[j].x * rstd * gv[j].x, v[j].y * rstd * gv[j].y); w.y = cvt_pk_bf16(v[j].z * rstd * gv[j].z, v[j].w * rstd * gv[j].w); o8[64 * j] = w; }
    }
}
__device__ __forceinline__ void final_norm_phase(float* out, const float* g, int gw, int ngw, int lane) {
    f32x4 gv[8];
#pragma unroll
    for (int j = 0; j < 8; ++j) gv[j] = *((const f32x4*)g + lane + 64 * j);
    for (int row = gw; row < MTOK; row += ngw) {
        float* xr = out + (size_t)row * DM;
        f32x4 v[8]; float s = 0.f;
#pragma unroll
        for (int j = 0; j < 8; ++j) { v[j] = *((const f32x4*)xr + lane + 64 * j); s += (v[j].x * v[j].x + v[j].y * v[j].y) + (v[j].z * v[j].z + v[j].w * v[j].w); }
        const float rstd = 1.0f / sqrtf(wave_sum(s) * (1.0f / DM) + RMS_EPS);
#pragma unroll
        for (int j = 0; j < 8; ++j) *((f32x4*)xr + lane + 64 * j) = v[j] * rstd * gv[j];
    }
}
__device__ __forceinline__ void prep_c_row(bf16_t* Prow, int tpos, const float* qg, const float* kg, int lane) {
    const int p = lane & 31, hf = p >> 4, i = p & 15;
    const int pos = hf ? (tpos & 63) : (tpos >> 6);
    const float freq = __builtin_amdgcn_exp2f(-(float)i * (13.287712379549449f / 16.0f));
    float sn, cs; sincosf((float)pos * freq, &sn, &cs);
    const int e1 = 32 * hf + i, e2 = e1 + 16;
#pragma unroll
    for (int k = 0; k < 5; ++k) {
        const int head = 2 * k + (lane >> 5);
        bf16_t* hp = Prow + C_CQ + head * 64;
        const float x1 = bf2f(hp[e1]), x2 = bf2f(hp[e2]);
        float ss = x1 * x1 + x2 * x2;
#pragma unroll
        for (int o = 1; o < 32; o <<= 1) ss += __shfl_xor(ss, o);
        const float rstd = 1.0f / sqrtf(ss * (1.0f / 64.0f) + RMS_EPS);
        const float* gn = head < 8 ? qg : kg;
        const float sc = head < 8 ? QSCALE : 1.0f;
        const float y1 = x1 * rstd * gn[e1], y2 = x2 * rstd * gn[e2];
        hp[e1] = (bf16_t)f2bf((y1 * cs - y2 * sn) * sc); hp[e2] = (bf16_t)f2bf((y2 * cs + y1 * sn) * sc);
    }
}

typedef const __attribute__((address_space(4))) Args* KArgs;
__device__ __forceinline__ KArgs kargs() { KArgs p = (KArgs)__builtin_amdgcn_kernarg_segment_ptr(); asm volatile("" : "+s"(p)); return p; }
#define CTX() \
    KArgs ka = kargs(); \
    int tid = threadIdx.x; asm volatile("" : "+v"(tid)); \
    const int lane = tid & 63, wave = __builtin_amdgcn_readfirstlane(tid >> 6); \
    int G = gridDim.x, bx = blockIdx.x; asm volatile("" : "+s"(G), "+s"(bx)); \
    const int vcu = (G % 8 == 0) ? (bx % 8) * (G / 8) + bx / 8 : bx; \
    const int gw = vcu * NWAVES + wave, ngw = G * NWAVES; \
    unsigned char* ws = ka->ws; \
    (void)lane; (void)gw; (void)ngw; (void)vcu;

__global__ void __launch_bounds__(NWAVES * 64, 2) fwd_kernel(Args args_unused) {
    extern __shared__ __attribute__((aligned(16))) unsigned char lds_raw[];
    LAS unsigned char* lds = (LAS unsigned char*)lds_raw;
    int lo, hi;
    XcdBarrier bar;
    {
        CTX();
        volatile LAS unsigned* MISC = (volatile LAS unsigned*)(lds + MISC_OFF);
        unsigned* ctl = (unsigned*)(ws + WS_CTL);
        for (int u = tid; u < (LDS_BYTES - LDSCTL_OFF) / 4; u += NWAVES * 64) ((LAS unsigned*)(lds + LDSCTL_OFF))[u] = 0u;
        __syncthreads();
        bar.bar = ctl + 1024; bar.x = 0; bar.st = nullptr;
        if (MK_N_LAUNCHES == 1) bar = xcd_barrier_post(ctl + 1024, MISC + 8);
        lo = ka->ph_lo; hi = ka->ph_hi;
    }
#define GRID_BAR() do { if (MK_N_LAUNCHES == 1) xcd_barrier(bar); } while (0)
#define IN(k) (lo <= (k) && (k) < hi)
#define BOTH(k) (IN(k) && IN((k) + 1))

    if ((PH_EN & 1) && IN(0)) {
        CTX();
        LAS float* scr = (LAS float*)(lds + wave * 16384);
        constexpr int I_IN = (DM / 64) * (NIN / 32), I_A = (512 / 64) * (DM / 32), I_B = (256 / 64) * (DM / 32), I_OUT = (DM / 64) * (DM / 32), I_UP = (DM / 64) * (DFF / 32), I_DN = (DFF / 64) * (DM / 32);
        constexpr int I_L = I_IN + 3 * I_A + I_B + I_OUT + I_UP + I_DN;
        for (int it = gw; it < DEPTH * I_L; it += ngw) {
            const int l = it / I_L; int r = it - l * I_L; unsigned char* wl = ws + WS_W + (size_t)l * WL_STRIDE;
            if (r < I_IN) { transpose_item(ka->w_in + (size_t)l * DM * NIN, DM, NIN, (bf16_t*)(wl + WL_IN), scr, r, lane); continue; } r -= I_IN;
            if (r < I_A) { transpose_item(ka->wa + (size_t)l * 512 * DM, 512, DM, (bf16_t*)(wl + WL_A), scr, r, lane); continue; } r -= I_A;
            if (r < I_B) { transpose_item(ka->wb + (size_t)l * 256 * DM, 256, DM, (bf16_t*)(wl + WL_B), scr, r, lane); continue; } r -= I_B;
            if (r < I_A) { transpose_item(ka->wc + (size_t)l * 512 * DM, 512, DM, (bf16_t*)(wl + WL_C), scr, r, lane); continue; } r -= I_A;
            if (r < I_A) { transpose_item(ka->wd + (size_t)l * 512 * DM, 512, DM, (bf16_t*)(wl + WL_D), scr, r, lane); continue; } r -= I_A;
            if (r < I_OUT) { transpose_item(ka->wout + (size_t)l * DM * DM, DM, DM, (bf16_t*)(wl + WL_OUT), scr, r, lane); continue; } r -= I_OUT;
            if (r < I_UP) { transpose_item(ka->wup + (size_t)l * DM * DFF, DM, DFF, (bf16_t*)(wl + WL_UP), scr, r, lane); continue; } r -= I_UP;
            transpose_item(ka->wdn + (size_t)l * DFF * DM, DFF, DM, (bf16_t*)(wl + WL_DN), scr, r, lane);
        }
        norm_phase(ka->xp, ka->xs, ka->norm_mix, (bf16_t*)(ws + WS_H), gw, ngw, lane);
        if (BOTH(0)) GRID_BAR();
    }

    for (int l = 0; l < DEPTH; ++l) {
        const int pb = 1 + 9 * l;
        if ((PH_EN & 2) && IN(pb + 0)) {
            CTX();
            const bf16_t* W = (const bf16_t*)(ws + WS_W + (size_t)l * WL_STRIDE + WL_IN); const bf16_t* H = (const bf16_t*)(ws + WS_H);
            pg8::OpsOne g{H, W, DM};
            pg8::StaticOrder S; S.init(MTOK, NIN, G, bx, 0);
            pg8::EpiInProj E{(bf16_t*)(ws + WS_P)};
            pg8::gemm_phase<pg8::EpiInProj, pg8::OpsOne>(lds, g, S, E);
            if (BOTH(pb + 0)) GRID_BAR();
        }
        if ((PH_EN & 4) && IN(pb + 1)) {
            {
                CTX();
                bf16_t* P = (bf16_t*)(ws + WS_P);
                const float* qg = ka->qg + l * 64; const float* kg = ka->kg + l * 64;
                for (int row = gw; row < MTOK; row += ngw) {
                    const int tpos = row < MPROMPT ? (row & 8191) : ((row - MPROMPT) & 2047);
                    prep_c_row(P + (size_t)row * PP, tpos, qg, kg, lane);
                }
            }
            {
                CTX();
                bf16_t* P = (bf16_t*)(ws + WS_P); bf16_t* YA = (bf16_t*)(ws + WS_YA);
                LAS char* shm = (LAS char*)lds; LAS float* tbl = (LAS float*)(lds + att::TBL_OFF);
                for (int a = bx; a < 768; a += G) {
                    int s, h, rb, R;
                    if (a < 512) { s = a >> 8; h = (a & 255) >> 5; rb = a & 31; R = 128; } else { const int a2 = a - 512; s = 2 + (a2 >> 6); h = (a2 & 63) >> 3; rb = a2 & 7; R = 32; }
                    const size_t row0 = s < 2 ? (size_t)s * 8192 : (size_t)MPROMPT + (size_t)(s - 2) * 2048;
                    const float* rbias = ka->rel_bias + ((size_t)l * 8 + h) * 465;
                    for (int i = tid; i < 465; i += NWAVES * 64) tbl[i] = rbias[i] * LOG2E;
                    att::TrA tr; tr.rb = rb; tr.R = R;
                    { const int a0 = 4 * rb - 4, a1 = 4 * rb + 3 - 4; const int lo0 = a0 < 0 ? 0 : (a0 > R - 8 ? R - 8 : a0), lo1 = a1 < 0 ? 0 : (a1 > R - 8 ? R - 8 : a1); tr.t0 = lo0; tr.t1 = lo1 + 8; }
                    tr.Pq = P + row0 * PP + C_AQ + h * 64; tr.Pk = P + row0 * PP + C_AK + h * 64; tr.Pv = P + row0 * PP + C_AV + h * 64; tr.Y = YA + row0 * 512 + h * 64; tr.tbl = tbl;
                    att::attn_unit<att::TrA>(tr, shm);
                }
            }
            {
                CTX();
                bf16_t* P = (bf16_t*)(ws + WS_P); bf16_t* OB = (bf16_t*)(ws + WS_OB); float* LSE = (float*)(ws + WS_LSE);
                LAS char* shm = (LAS char*)lds;
                for (int b = bx; b < 1280; b += G) {
                    int s, hh, g, res, fb, L;
                    if (b < 768) { s = b / 384; const int rem = b % 384; hh = rem / 96; const int u = rem % 96; g = u >> 5; const int v = u & 31; L = 8192;
                        if (g == 0) { res = 0; fb = v; } else if (g == 1) { res = v >> 3; fb = v & 7; } else { res = v >> 1; fb = v & 1; } }
                    else { const int b2 = b - 768; s = 2 + (b2 >> 7); const int rem = b2 & 127; hh = rem >> 5; const int v = rem & 31; L = 2048;
                        if (v < 8) { g = 0; res = 0; fb = v; } else if (v < 16) { g = 1; res = (v - 8) >> 1; fb = (v - 8) & 1; } else { g = 2; res = v - 16; fb = 0; } }
                    const int d = g == 0 ? 1 : (g == 1 ? 4 : 16); const int n = L / d;
                    const size_t row0 = s < 2 ? (size_t)s * 8192 : (size_t)MPROMPT + (size_t)(s - 2) * 2048;
                    const int hg = 4 * g + hh;
                    att::TrB tr; tr.fb = fb; tr.n = n; tr.d = d; tr.res = res;
                    tr.slope2 = __builtin_amdgcn_exp2f(-(float)(8 * (hg + 1)) / 12.0f) * (float)d * LOG2E;
                    { int t0 = fb == 0 ? 1 : 0; int t1 = 6; const int kb = 256 * fb - 64; while (t1 > t0 && kb + 64 * (t1 - 1) >= n) --t1; tr.t0 = t0; tr.t1 = t1; }
                    tr.Pq = P + row0 * PP + C_BQ + hg * 64; tr.Pk = P + row0 * PP + C_BK + hg * 64; tr.Pv = P + row0 * PP + C_BV + hg * 64;
                    tr.O = OB + ((size_t)g * MTOK + row0) * 256 + hh * 64; tr.LSE = LSE + ((size_t)g * MTOK + row0) * 4 + hh;
                    att::attn_unit<att::TrB>(tr, shm);
                }
            }
            {
                CTX();
                bf16_t* P = (bf16_t*)(ws + WS_P); bf16_t* YD = (bf16_t*)(ws + WS_YD);
                LAS char* shm = (LAS char*)lds;
                for (int dI = bx; dI < 768; dI += G) {
                    int s, kvh, qb, L;
                    if (dI < 512) { s = dI >> 8; kvh = (dI & 255) >> 7; qb = dI & 127; L = 8192; } else { const int d2 = dI - 512; s = 2 + (d2 >> 6); kvh = (d2 & 63) >> 5; qb = d2 & 31; L = 2048; }
                    const size_t row0 = s < 2 ? (size_t)s * 8192 : (size_t)MPROMPT + (size_t)(s - 2) * 2048;
                    att::TrD tr; tr.qb = qb; tr.L = L; tr.kvh = kvh;
                    tr.t0 = qb < 2 ? 2 - qb : 0; { const int lim = L / 64 - qb + 2; tr.t1 = lim < 5 ? lim : 5; }
                    tr.Pq = P + row0 * PP + C_DQ + 4 * kvh * 64; tr.Pk = P + row0 * PP + C_DK + kvh * 64; tr.Pv = P + row0 * PP + C_DV + kvh * 64;
                    tr.Y = YD + row0 * 512 + 4 * kvh * 64; tr.sink = ka->sink + l * 8 + 4 * kvh;
                    att::attn_unit<att::TrD>(tr, shm);
                }
            }
            if (BOTH(pb + 1)) GRID_BAR();
        }
        if ((PH_EN & 8) && IN(pb + 2)) {
            {
                CTX();
                bf16_t* P = (bf16_t*)(ws + WS_P); bf16_t* YC = (bf16_t*)(ws + WS_YC);
                LAS char* shm = (LAS char*)lds;
                for (int c = vcu; c < 768; c += G) {
                    int s, h, qb, L;
                    if (c < 512) { s = c >> 8; h = (c & 255) >> 5; qb = c & 31; L = 8192; } else { const int c2 = c - 512; s = 2 + (c2 >> 6); h = (c2 & 63) >> 3; qb = c2 & 7; L = 2048; }
                    const size_t row0 = s < 2 ? (size_t)s * 8192 : (size_t)MPROMPT + (size_t)(s - 2) * 2048;
                    att::TrC tr; tr.qb = qb; tr.t0 = 0; tr.t1 = L / 64;
                    tr.Pq = P + row0 * PP + C_CQ + h * 64; tr.Pk = P + row0 * PP + C_CK + (h >> 2) * 64; tr.Pv = P + row0 * PP + C_CV + (h >> 2) * 64; tr.Y = YC + row0 * 512 + h * 64;
                    att::attn_unit<att::TrC>(tr, shm);
                }
            }
            {
                CTX();
                const bf16_t* OB = (const bf16_t*)(ws + WS_OB); const float* LSE = (const float*)(ws + WS_LSE); bf16_t* YB = (bf16_t*)(ws + WS_YB);
                for (int it = bx * (NWAVES * 64) + tid; it < MTOK * 32; it += G * NWAVES * 64) {
                    const int row = it >> 5, ch = it & 31, hh = ch >> 3;
                    const float l0 = LSE[((size_t)0 * MTOK + row) * 4 + hh], l1 = LSE[((size_t)1 * MTOK + row) * 4 + hh], l2 = LSE[((size_t)2 * MTOK + row) * 4 + hh];
                    const float mx = fmaxf(l0, fmaxf(l1, l2));
                    float w0 = __builtin_amdgcn_exp2f(l0 - mx), w1 = __builtin_amdgcn_exp2f(l1 - mx), w2 = __builtin_amdgcn_exp2f(l2 - mx);
                    const float inv = 1.0f / (w0 + w1 + w2); w0 *= inv; w1 *= inv; w2 *= inv;
                    const u32x4 a = *(const u32x4*)(OB + ((size_t)0 * MTOK + row) * 256 + ch * 8), b = *(const u32x4*)(OB + ((size_t)1 * MTOK + row) * 256 + ch * 8), c = *(const u32x4*)(OB + ((size_t)2 * MTOK + row) * 256 + ch * 8);
                    u32x4 o;
                    o.x = cvt_pk_bf16(w0 * bf_lo(a.x) + w1 * bf_lo(b.x) + w2 * bf_lo(c.x), w0 * bf_hi(a.x) + w1 * bf_hi(b.x) + w2 * bf_hi(c.x));
                    o.y = cvt_pk_bf16(w0 * bf_lo(a.y) + w1 * bf_lo(b.y) + w2 * bf_lo(c.y), w0 * bf_hi(a.y) + w1 * bf_hi(b.y) + w2 * bf_hi(c.y));
                    o.z = cvt_pk_bf16(w0 * bf_lo(a.z) + w1 * bf_lo(b.z) + w2 * bf_lo(c.z), w0 * bf_hi(a.z) + w1 * bf_hi(b.z) + w2 * bf_hi(c.z));
                    o.w = cvt_pk_bf16(w0 * bf_lo(a.w) + w1 * bf_lo(b.w) + w2 * bf_lo(c.w), w0 * bf_hi(a.w) + w1 * bf_hi(b.w) + w2 * bf_hi(c.w));
                    *(u32x4*)(YB + (size_t)row * 256 + ch * 8) = o;
                }
            }
            if (BOTH(pb + 2)) GRID_BAR();
        }
        if ((PH_EN & 16) && IN(pb + 3)) {
            CTX();
            unsigned char* wl = ws + WS_W + (size_t)l * WL_STRIDE;
            pg8::OpsBranch g{ws, wl};
            pg8::StaticOrder S; S.init(MTOK, DM, G, bx, 2);
            pg8::EpiGated E{(bf16_t*)(ws + WS_H), (const bf16_t*)(ws + WS_P)};
            pg8::gemm_phase<pg8::EpiGated, pg8::OpsBranch>(lds, g, S, E);
            if (BOTH(pb + 3)) GRID_BAR();
        }
        if ((PH_EN & 32) && IN(pb + 4)) {
            CTX();
            const bf16_t* W = (const bf16_t*)(ws + WS_W + (size_t)l * WL_STRIDE + WL_OUT); const bf16_t* H = (const bf16_t*)(ws + WS_H);
            pg8::OpsOne g{H, W, DM};
            pg8::StaticOrder S; S.init(MTOK, DM, G, bx, 0);
            float* out = ka->out;
            pg8::EpiResid E{l == 0 ? ka->xp : out, l == 0 ? ka->xs : out + (size_t)MPROMPT * DM, out};
            pg8::gemm_phase<pg8::EpiResid, pg8::OpsOne>(lds, g, S, E);
            if (BOTH(pb + 4)) GRID_BAR();
        }
        if ((PH_EN & 64) && IN(pb + 5)) {
            CTX();
            const float* out = ka->out;
            norm_phase(out, out + (size_t)MPROMPT * DM, ka->norm_mlp + (size_t)l * DM, (bf16_t*)(ws + WS_H), gw, ngw, lane);
            if (BOTH(pb + 5)) GRID_BAR();
        }
        if ((PH_EN & 128) && IN(pb + 6)) {
            CTX();
            const bf16_t* W = (const bf16_t*)(ws + WS_W + (size_t)l * WL_STRIDE + WL_UP); const bf16_t* H = (const bf16_t*)(ws + WS_H);
            pg8::OpsOne g{H, W, DM};
            pg8::StaticOrder S; S.init(MTOK, DFF, G, bx, 0);
            pg8::EpiRelu2 E{(bf16_t*)(ws + WS_P), DFF};
            pg8::gemm_phase<pg8::EpiRelu2, pg8::OpsOne>(lds, g, S, E);
            if (BOTH(pb + 6)) GRID_BAR();
        }
        if ((PH_EN & 256) && IN(pb + 7)) {
            CTX();
            const bf16_t* W = (const bf16_t*)(ws + WS_W + (size_t)l * WL_STRIDE + WL_DN); const bf16_t* U = (const bf16_t*)(ws + WS_P);
            pg8::OpsOne g{U, W, DFF};
            pg8::StaticOrder S; S.init(MTOK, DM, G, bx, 0);
            float* out = ka->out;
            pg8::EpiResid E{out, out + (size_t)MPROMPT * DM, out};
            pg8::gemm_phase<pg8::EpiResid, pg8::OpsOne>(lds, g, S, E);
            if (BOTH(pb + 7)) GRID_BAR();
        }
        if ((PH_EN & 512) && IN(pb + 8)) {
            CTX();
            float* out = ka->out;
            if (l + 1 < DEPTH) norm_phase(out, out + (size_t)MPROMPT * DM, ka->norm_mix + (size_t)(l + 1) * DM, (bf16_t*)(ws + WS_H), gw, ngw, lane);
            else final_norm_phase(out, ka->norm_final, gw, ngw, lane);
            if (BOTH(pb + 8)) GRID_BAR();
        }
    }
#undef IN
#undef BOTH
#undef GRID_BAR
}

extern "C" void kernel_launch(void* const* d_in, const int* in_sizes, int n_in, void* d_out, int out_size, void* d_ws, size_t ws_size, hipStream_t stream) {
    static int grid = 0;
    if (grid == 0) {
        if (n_in != 17 || in_sizes[0] != MPROMPT * DM || out_size != MTOK * DM || ws_size < WS_END) { fprintf(stderr, "kernel_launch: unexpected shapes / workspace (%d inputs, ws %zu, need %zu)\n", n_in, ws_size, (size_t)WS_END); grid = -1; return; }
        int dev = 0, cus = 0, per_cu = 0;
        if (hipGetDevice(&dev) != hipSuccess || hipDeviceGetAttribute(&cus, hipDeviceAttributeMultiprocessorCount, dev) != hipSuccess) { grid = -1; return; }
        if (hipFuncSetAttribute((const void*)fwd_kernel, hipFuncAttributeMaxDynamicSharedMemorySize, LDS_BYTES) != hipSuccess) { fprintf(stderr, "kernel_launch: hipFuncSetAttribute failed\n"); grid = -1; return; }
        if (hipOccupancyMaxActiveBlocksPerMultiprocessor(&per_cu, (const void*)fwd_kernel, NWAVES * 64, LDS_BYTES) != hipSuccess || per_cu < 1) { fprintf(stderr, "kernel_launch: occupancy query says %d\n", per_cu); }
        (void)hipGetLastError();
        grid = cus;
    }
    if (grid < 0) return;
    if (hipMemsetAsync((char*)d_ws + WS_CTL, 0, CTL_ZERO_BYTES, stream) != hipSuccess) return;
    Args a{};
    a.xp = (const float*)d_in[0]; a.xs = (const float*)d_in[1]; a.norm_mix = (const float*)d_in[2]; a.w_in = (const float*)d_in[3]; a.rel_bias = (const float*)d_in[4];
    a.qg = (const float*)d_in[5]; a.kg = (const float*)d_in[6]; a.sink = (const float*)d_in[7]; a.wa = (const float*)d_in[8]; a.wb = (const float*)d_in[9]; a.wc = (const float*)d_in[10];
    a.wd = (const float*)d_in[11]; a.wout = (const float*)d_in[12]; a.norm_mlp = (const float*)d_in[13]; a.wup = (const float*)d_in[14]; a.wdn = (const float*)d_in[15]; a.norm_final = (const float*)d_in[16];
    a.out = (float*)d_out; a.ws = (unsigned char*)d_ws;
    constexpr int NPH = 1 + 9 * DEPTH;
    if (MK_N_LAUNCHES == 1) {
        a.ph_lo = 0; a.ph_hi = NPH;
        hipLaunchKernelGGL(fwd_kernel, dim3(grid), dim3(NWAVES * 64), LDS_BYTES, stream, a);
    } else {
        for (int p = 0; p < NPH; ++p) { a.ph_lo = p; a.ph_hi = p + 1; hipLaunchKernelGGL(fwd_kernel, dim3(grid), dim3(NWAVES * 64), LDS_BYTES, stream, a); }
    }
}
```
